# Optimizing an MI355X kernel written in HIP

```python
import math
import jax
import jax.numpy as jnp
from jax import lax
import numpy as np


D_MODEL = 1024
BATCH = 4
SEQ = 4096
DEPTH = 4

N_MIXERS = 3
N_A = (DEPTH + 2) // N_MIXERS
N_B = (DEPTH + 1) // N_MIXERS
N_C = DEPTH // N_MIXERS

DA_HEADS = 8
DA_HEAD_DIM = 64
DA_QK = 2 * DA_HEADS * DA_HEAD_DIM
DA_V = DA_HEADS * 2 * DA_HEAD_DIM
HG_EXPAND = 128
HG_HEADS = D_MODEL // HG_EXPAND
HG_KDIM = HG_EXPAND
HG_VDIM = D_MODEL // HG_HEADS
HG_FDIM = HG_HEADS * HG_KDIM
HG_CHUNK = 64
SW_Q_HEADS = 16
SW_KV_HEADS = 2
SW_HEAD_DIM = 64
SW_GROUP = SW_Q_HEADS // SW_KV_HEADS
SW_WINDOW = 128
SW_IN = SW_Q_HEADS * SW_HEAD_DIM + 2 * SW_KV_HEADS * SW_HEAD_DIM
N_BUCKETS = 32
MAX_DISTANCE = 128
N_BIAS_HEADS = 16
BLOCK = 128
D_FF = 4 * D_MODEL
PLE_DIM = 256
ALPHA = (2 * DEPTH) ** 0.25
BETA = (8 * DEPTH) ** -0.25
LN_EPS = 1e-5
RMS_EPS = 1e-6

kernel_name = "hybrid_diffattn_hgrn2_swa_sink_trunk"


def layer_norm(x, g, b):
    x32 = x.astype(jnp.float32)
    mu = jnp.mean(x32, axis=-1, keepdims=True)
    var = jnp.mean(jnp.square(x32 - mu), axis=-1, keepdims=True)
    y = (x32 - mu) * lax.rsqrt(var + LN_EPS) * g.astype(jnp.float32) + b.astype(jnp.float32)
    return y.astype(x.dtype)


def rms_norm(x, g):
    x32 = x.astype(jnp.float32)
    y = x32 * lax.rsqrt(jnp.mean(jnp.square(x32), axis=-1, keepdims=True) + RMS_EPS)
    return (y * g.astype(jnp.float32)).astype(x.dtype)


def t5_bucket(rel):
    n = jnp.maximum(rel, 0)
    max_exact = N_BUCKETS // 2
    nf = jnp.maximum(n, 1).astype(jnp.float32)
    large = max_exact + (jnp.log(nf / max_exact) / math.log(MAX_DISTANCE / max_exact)
                         * (N_BUCKETS - max_exact)).astype(jnp.int32)
    large = jnp.minimum(large, N_BUCKETS - 1)
    return jnp.where(n < max_exact, n, large)


def diff_attention(h, w_in, lam, subln, w_out, rel_bias, layer_idx):
    B, S, _ = h.shape
    H, d = DA_HEADS, DA_HEAD_DIM
    q, k, v = jnp.split(h @ w_in, [DA_QK, 2 * DA_QK], axis=-1)
    q = q.reshape(B, S, 2 * H, d).transpose(0, 2, 1, 3) * (d ** -0.5)
    k = k.reshape(B, S, 2 * H, d).transpose(0, 2, 1, 3)
    v = v.reshape(B, S, H, 2 * d).transpose(0, 2, 1, 3)
    lam_init = 0.8 - 0.6 * math.exp(-0.3 * layer_idx)
    lam32 = lam.astype(jnp.float32)
    lam_full = jnp.exp(jnp.sum(lam32[0] * lam32[1])) - jnp.exp(jnp.sum(lam32[2] * lam32[3])) + lam_init
    pos = jnp.arange(S, dtype=jnp.int32)
    outs = []
    for blk in range(S // BLOCK):
        qs = blk * BLOCK
        ke = qs + BLOCK
        s = jnp.einsum('bmqd,bmkd->bmqk', q[:, :, qs:ke], k[:, :, :ke]).astype(jnp.float32)
        rel = pos[qs:ke, None] - pos[None, :ke]
        bias = rel_bias[t5_bucket(rel)].astype(jnp.float32).transpose(2, 0, 1)
        s = jnp.where(rel >= 0, s + bias, -jnp.inf)
        a = jax.nn.softmax(s, axis=-1).reshape(B, H, 2, BLOCK, ke)
        a = a[:, :, 0] - lam_full * a[:, :, 1]
        outs.append(jnp.einsum('bhqk,bhkv->bhqv', a.astype(v.dtype), v[:, :, :ke]))
    o = jnp.concatenate(outs, axis=2)
    o = rms_norm(o, subln) * (1.0 - lam_init)
    o = o.transpose(0, 2, 1, 3).reshape(B, S, DA_V)
    return o @ w_out


def hgrn2(h, w_in, gnorm, w_out, lower_bound):
    B, S, _ = h.shape
    H, dk, dv, C = HG_HEADS, HG_KDIM, HG_VDIM, HG_CHUNK
    q, f, i, g = jnp.split(h @ w_in, 4, axis=-1)
    q = jax.nn.silu(q.astype(jnp.float32))
    lb = lower_bound.astype(jnp.float32)
    f = lb + (1.0 - lb) * jax.nn.sigmoid(f.astype(jnp.float32))
    logf = jnp.log(f)
    kin = 1.0 - f

    def to_chunks(t, dim):
        return t.reshape(B, S // C, C, H, dim).transpose(1, 0, 3, 2, 4)

    qc, kc, gc = to_chunks(q, dk), to_chunks(kin, dk), to_chunks(logf, dk)
    vc = to_chunks(i.astype(jnp.float32), dv)
    causal = jnp.tril(jnp.ones((C, C), dtype=bool))

    def step(state, inp):
        q_, k_, v_, g_ = inp
        G = jnp.cumsum(g_, axis=2)
        G_last = G[:, :, -1:, :]
        o_inter = jnp.einsum('bhtk,bhkv->bhtv', q_ * jnp.exp(G), state)
        diff = G[:, :, :, None, :] - G[:, :, None, :, :]
        decay = jnp.exp(jnp.where(causal[:, :, None], diff, -jnp.inf))
        A = jnp.einsum('bhtk,bhsk,bhtsk->bhts', q_, k_, decay)
        o = o_inter + jnp.einsum('bhts,bhsv->bhtv', A, v_)
        new_state = (jnp.exp(G_last[:, :, 0, :])[..., None] * state
                     + jnp.einsum('bhsk,bhsv->bhkv', k_ * jnp.exp(G_last - G), v_))
        return new_state, o

    s0 = jnp.zeros((B, H, dk, dv), jnp.float32)
    _, o = lax.scan(step, s0, (qc, kc, vc, gc))
    o = o.transpose(1, 0, 3, 2, 4).reshape(B, S, H, dv)
    o = rms_norm(o, gnorm) * jax.nn.silu(g.astype(jnp.float32).reshape(B, S, H, dv))
    o = o.reshape(B, S, H * dv).astype(h.dtype)
    return o @ w_out


def swa_sink_attention(h, w_in, sinks, w_out, rel_bias):
    B, S, _ = h.shape
    Hq, Hk, G, d, W = SW_Q_HEADS, SW_KV_HEADS, SW_GROUP, SW_HEAD_DIM, BLOCK
    NB = S // W
    q, k, v = jnp.split(h @ w_in, [Hq * d, Hq * d + Hk * d], axis=-1)
    q = q.reshape(B, NB, W, Hk, G, d) * (d ** -0.5)
    k = k.reshape(B, NB, W, Hk, d)
    v = v.reshape(B, NB, W, Hk, d)

    def prev_block(t):
        return jnp.concatenate([jnp.zeros_like(t[:, :1]), t[:, :-1]], axis=1)

    kb = jnp.concatenate([prev_block(k), k], axis=2)
    vb = jnp.concatenate([prev_block(v), v], axis=2)
    s = jnp.einsum('bnqhgd,bnkhd->bnhgqk', q, kb).astype(jnp.float32)
    qi = jnp.arange(W, dtype=jnp.int32)[:, None]
    kj = jnp.arange(2 * W, dtype=jnp.int32)[None, :]
    rel = qi + W - kj
    bias = rel_bias[t5_bucket(rel)].astype(jnp.float32).transpose(2, 0, 1).reshape(Hk, G, W, 2 * W)
    in_window = (rel >= 0) & (rel < SW_WINDOW)
    key_valid = (jnp.arange(NB, dtype=jnp.int32)[:, None, None] * W + kj[None] - W) >= 0
    mask = in_window[None] & key_valid
    s = jnp.where(mask[None, :, None, None], s + bias, -jnp.inf)
    sink = sinks.astype(jnp.float32).reshape(Hk, G)[None, None, :, :, None, None]
    m = jnp.maximum(jnp.max(s, axis=-1, keepdims=True), sink)
    e = jnp.exp(s - m)
    a = e / (jnp.sum(e, axis=-1, keepdims=True) + jnp.exp(sink - m))
    o = jnp.einsum('bnhgqk,bnkhd->bnqhgd', a.astype(vb.dtype), vb).reshape(B, S, Hq * d)
    return o @ w_out


def setup_inputs(seed: int = 0) -> dict:
    key = jax.random.key(seed)
    ks = jax.random.split(key, 24)
    f32 = jnp.float32
    D = D_MODEL

    def nrm(k, shape, scale):
        return jax.random.normal(k, shape, f32) * scale

    return {
        "x": nrm(ks[0], (BATCH, SEQ, D), 1.0),
        "p": nrm(ks[1], (DEPTH, BATCH, SEQ, PLE_DIM), 1.0),
        "rel_bias": nrm(ks[2], (N_BUCKETS, N_BIAS_HEADS), 0.5),
        "hg_lower_bound": nrm(ks[3], (DEPTH, HG_FDIM), 0.1),
        "da_w_in": nrm(ks[4], (N_A, D, 2 * DA_QK + DA_V), D ** -0.5),
        "da_lambda": nrm(ks[5], (N_A, 4, DA_HEAD_DIM), 0.1),
        "da_subln": 1.0 + nrm(ks[6], (N_A, 2 * DA_HEAD_DIM), 0.02),
        "da_w_out": nrm(ks[7], (N_A, DA_V, D), DA_V ** -0.5 * BETA),
        "hg_w_in": nrm(ks[8], (N_B, D, 2 * HG_FDIM + 2 * D), D ** -0.5),
        "hg_gnorm": 1.0 + nrm(ks[9], (N_B, HG_VDIM), 0.02),
        "hg_w_out": nrm(ks[10], (N_B, D, D), D ** -0.5 * BETA),
        "sw_w_in": nrm(ks[11], (N_C, D, SW_IN), D ** -0.5),
        "sw_sinks": nrm(ks[12], (N_C, SW_Q_HEADS), 0.5),
        "sw_w_out": nrm(ks[13], (N_C, SW_Q_HEADS * SW_HEAD_DIM, D), (SW_Q_HEADS * SW_HEAD_DIM) ** -0.5 * BETA),
        "ln_g": 1.0 + nrm(ks[14], (DEPTH, 2, D), 0.02),
        "ln_b": nrm(ks[15], (DEPTH, 2, D), 0.02),
        "w_up": nrm(ks[16], (DEPTH, D, D_FF), D ** -0.5),
        "w_down": nrm(ks[17], (DEPTH, D_FF, D), D_FF ** -0.5 * BETA),
        "w_ple": nrm(ks[18], (DEPTH, PLE_DIM, D), PLE_DIM ** -0.5 * 0.5),
        "w_ple_gate": nrm(ks[19], (DEPTH, D, D), D ** -0.5),
    }


def reference(x, p, rel_bias, hg_lower_bound, da_w_in, da_lambda, da_subln, da_w_out,
              hg_w_in, hg_gnorm, hg_w_out, sw_w_in, sw_sinks, sw_w_out,
              ln_g, ln_b, w_up, w_down, w_ple, w_ple_gate):
    lb_sm = jax.nn.softmax(hg_lower_bound.astype(jnp.float32), axis=0)
    lb_all = jnp.cumsum(lb_sm, axis=0) - lb_sm[0]
    h = x
    for i in range(DEPTH):
        kind, j = i % N_MIXERS, i // N_MIXERS
        if kind == 0:
            y = diff_attention(h, da_w_in[j], da_lambda[j], da_subln[j], da_w_out[j], rel_bias, i)
        elif kind == 1:
            y = hgrn2(h, hg_w_in[j], hg_gnorm[j], hg_w_out[j], lb_all[i])
        else:
            y = swa_sink_attention(h, sw_w_in[j], sw_sinks[j], sw_w_out[j], rel_bias)
        h = layer_norm(ALPHA * h + y, ln_g[i, 0], ln_b[i, 0])
        u = jnp.square(jax.nn.relu(h @ w_up[i])) @ w_down[i]
        h = layer_norm(ALPHA * h + u, ln_g[i, 1], ln_b[i, 1])
        h = h + jax.nn.sigmoid(h @ w_ple_gate[i]) * (p[i] @ w_ple[i])
    return h
```

```cpp
#include <hip/hip_runtime.h>
#include <cstdio>
#include <cstdint>
#include <cmath>

namespace nv {
constexpr int Dm = 1024, Bz = 4, S = 4096, M = Bz * S, DEPTH = 4, DFF = 4096, PLE = 256;
constexpr float ALPHA = 1.681792830507429f;
constexpr float LN_EPS = 1e-5f, RMS_EPS = 1e-6f;

__device__ __forceinline__ int t5_bucket(int n) {
    if (n < 16) return n;
    float v = logf((float)n / 16.0f) / 2.0794415416798357f * 16.0f;
    int l = 16 + (int)v;
    return l < 31 ? l : 31;
}
__device__ __forceinline__ float sigmoidf_(float x) { return 1.0f / (1.0f + expf(-x)); }
__device__ __forceinline__ float siluf_(float x) { return x / (1.0f + expf(-x)); }

template <int EPI>
__global__ void __launch_bounds__(256) sgemm(const float* __restrict__ A, int lda, const float* __restrict__ W, int ldw, float* __restrict__ C, int ldc, int K) {
    __shared__ float As[8][128 + 4];
    __shared__ float Bs[8][128 + 4];
    const int t = threadIdx.x, tx = t & 15, ty = t >> 4;
    const int m0 = blockIdx.y * 128, n0 = blockIdx.x * 128;
    float acc[8][8];
#pragma unroll
    for (int i = 0; i < 8; ++i)
#pragma unroll
        for (int j = 0; j < 8; ++j) acc[i][j] = 0.f;
    const int ar = t >> 1, ak = (t & 1) * 4;
    const int bk = t >> 5, bn = (t & 31) * 4;
    for (int k0 = 0; k0 < K; k0 += 8) {
        const float4 av = *(const float4*)(A + (size_t)(m0 + ar) * lda + k0 + ak);
        const float4 bv = *(const float4*)(W + (size_t)(k0 + bk) * ldw + n0 + bn);
        __syncthreads();
        As[ak + 0][ar] = av.x; As[ak + 1][ar] = av.y; As[ak + 2][ar] = av.z; As[ak + 3][ar] = av.w;
        *(float4*)&Bs[bk][bn] = bv;
        __syncthreads();
#pragma unroll
        for (int k = 0; k < 8; ++k) {
            float a[8], b[8];
#pragma unroll
            for (int i = 0; i < 4; ++i) { a[i] = As[k][ty * 4 + i]; a[4 + i] = As[k][64 + ty * 4 + i]; }
#pragma unroll
            for (int j = 0; j < 4; ++j) { b[j] = Bs[k][tx * 4 + j]; b[4 + j] = Bs[k][64 + tx * 4 + j]; }
#pragma unroll
            for (int i = 0; i < 8; ++i)
#pragma unroll
                for (int j = 0; j < 8; ++j) acc[i][j] = fmaf(a[i], b[j], acc[i][j]);
        }
    }
#pragma unroll
    for (int i = 0; i < 8; ++i) {
        const int r = m0 + (i < 4 ? ty * 4 + i : 64 + ty * 4 + i - 4);
#pragma unroll
        for (int jh = 0; jh < 2; ++jh) {
            float4 o;
            float v0 = acc[i][jh * 4 + 0], v1 = acc[i][jh * 4 + 1], v2 = acc[i][jh * 4 + 2], v3 = acc[i][jh * 4 + 3];
            if (EPI == 1) { v0 = v0 > 0.f ? v0 * v0 : 0.f; v1 = v1 > 0.f ? v1 * v1 : 0.f; v2 = v2 > 0.f ? v2 * v2 : 0.f; v3 = v3 > 0.f ? v3 * v3 : 0.f; }
            o.x = v0; o.y = v1; o.z = v2; o.w = v3;
            *(float4*)(C + (size_t)r * ldc + n0 + jh * 64 + tx * 4) = o;
        }
    }
}

__global__ void __launch_bounds__(256) ln_kernel(const float* h, const float* __restrict__ y, const float* __restrict__ g, const float* __restrict__ b, float* out) {
    __shared__ float red[8];
    const int row = blockIdx.x, t = threadIdx.x;
    const float4 hv = *(const float4*)(h + (size_t)row * Dm + t * 4), yv = *(const float4*)(y + (size_t)row * Dm + t * 4);
    float v[4] = {ALPHA * hv.x + yv.x, ALPHA * hv.y + yv.y, ALPHA * hv.z + yv.z, ALPHA * hv.w + yv.w};
    float s = (v[0] + v[1]) + (v[2] + v[3]);
    for (int o = 32; o > 0; o >>= 1) s += __shfl_xor(s, o);
    if ((t & 63) == 0) red[t >> 6] = s;
    __syncthreads();
    const float mean = (red[0] + red[1] + red[2] + red[3]) * (1.0f / Dm);
    float q = 0.f;
#pragma unroll
    for (int i = 0; i < 4; ++i) { v[i] -= mean; q += v[i] * v[i]; }
    for (int o = 32; o > 0; o >>= 1) q += __shfl_xor(q, o);
    if ((t & 63) == 0) red[4 + (t >> 6)] = q;
    __syncthreads();
    const float rstd = 1.0f / sqrtf((red[4] + red[5] + red[6] + red[7]) * (1.0f / Dm) + LN_EPS);
    const float4 gv = *(const float4*)(g + t * 4), bv = *(const float4*)(b + t * 4);
    float4 o; o.x = v[0] * rstd * gv.x + bv.x; o.y = v[1] * rstd * gv.y + bv.y; o.z = v[2] * rstd * gv.z + bv.z; o.w = v[3] * rstd * gv.w + bv.w;
    *(float4*)(out + (size_t)row * Dm + t * 4) = o;
}

__global__ void ple_kernel(float* __restrict__ h, const float* __restrict__ G, const float* __restrict__ P, int n) {
    const int i = blockIdx.x * blockDim.x + threadIdx.x;
    if (i < n) h[i] = h[i] + sigmoidf_(G[i]) * P[i];
}

__global__ void lb_kernel(const float* __restrict__ lb, float* __restrict__ lb_all) {
    const int c = blockIdx.x * blockDim.x + threadIdx.x;
    if (c >= 1024) return;
    float v[DEPTH], mx = -1e30f;
    for (int i = 0; i < DEPTH; ++i) { v[i] = lb[i * 1024 + c]; mx = fmaxf(mx, v[i]); }
    float s = 0.f;
    for (int i = 0; i < DEPTH; ++i) { v[i] = expf(v[i] - mx); s += v[i]; }
    float cum = 0.f;
    for (int i = 0; i < DEPTH; ++i) { if (i > 0) cum += v[i] / s; lb_all[i * 1024 + c] = cum; }
}

__global__ void __launch_bounds__(256) da_attn_naive(const float* __restrict__ qkv, const float* __restrict__ rel_bias, const float* __restrict__ lam4, float lam_init, float* __restrict__ o_raw) {
    int bid = blockIdx.x;
    const int qblk = bid % (S / 256); bid /= (S / 256);
    const int ch = bid % 8; bid /= 8;
    const int h = bid % 8; const int b = bid / 8;
    const int q = qblk * 256 + threadIdx.x;
    float s01 = 0.f, s23 = 0.f;
    for (int i = 0; i < 64; ++i) { s01 += lam4[i] * lam4[64 + i]; s23 += lam4[128 + i] * lam4[192 + i]; }
    const float lam = expf(s01) - expf(s23) + lam_init;
    const float* qrow = qkv + (size_t)(b * S + q) * 3072 + (2 * h) * 64;
    float q1[64], q2[64];
#pragma unroll
    for (int i = 0; i < 64; ++i) { q1[i] = qrow[i] * 0.125f; q2[i] = qrow[64 + i] * 0.125f; }
    float m1 = -INFINITY, m2 = -INFINITY, l1 = 0.f, l2 = 0.f, O1[16], O2[16];
#pragma unroll
    for (int i = 0; i < 16; ++i) { O1[i] = 0.f; O2[i] = 0.f; }
    const int qmax = qblk * 256 + 255;
    for (int kv = 0; kv <= qmax; ++kv) {
        const float* krow = qkv + (size_t)(b * S + kv) * 3072 + 1024 + (2 * h) * 64;
        const float* vrow = qkv + (size_t)(b * S + kv) * 3072 + 2048 + h * 128 + ch * 16;
        float d1 = 0.f, d2 = 0.f;
#pragma unroll
        for (int i = 0; i < 64; ++i) { d1 = fmaf(q1[i], krow[i], d1); d2 = fmaf(q2[i], krow[64 + i], d2); }
        if (kv <= q) {
            const int bk = t5_bucket(q - kv);
            d1 += rel_bias[bk * 16 + 2 * h]; d2 += rel_bias[bk * 16 + 2 * h + 1];
            const float n1 = fmaxf(m1, d1), n2 = fmaxf(m2, d2);
            const float a1 = expf(m1 - n1), a2 = expf(m2 - n2), p1 = expf(d1 - n1), p2 = expf(d2 - n2);
            l1 = l1 * a1 + p1; l2 = l2 * a2 + p2; m1 = n1; m2 = n2;
#pragma unroll
            for (int i = 0; i < 16; ++i) { const float v = vrow[i]; O1[i] = O1[i] * a1 + p1 * v; O2[i] = O2[i] * a2 + p2 * v; }
        }
    }
    float* orow = o_raw + (size_t)(b * S + q) * 1024 + h * 128 + ch * 16;
#pragma unroll
    for (int i = 0; i < 16; ++i) orow[i] = O1[i] / l1 - lam * (O2[i] / l2);
}

__global__ void __launch_bounds__(256) rms128_kernel(const float* x, const float* __restrict__ w, float scale, const float* __restrict__ gate, int gate_ld, float* o) {
    const int wid = threadIdx.x >> 6, lane = threadIdx.x & 63;
    const int item = blockIdx.x * 4 + wid;
    const int row = item >> 3, grp = item & 7;
    const float* xr = x + (size_t)row * 1024 + grp * 128;
    float a = xr[lane], c = xr[64 + lane];
    float s = a * a + c * c;
    for (int off = 32; off > 0; off >>= 1) s += __shfl_xor(s, off);
    const float r = 1.0f / sqrtf(s * (1.0f / 128.0f) + RMS_EPS);
    float oa = a * r * w[lane] * scale, oc = c * r * w[64 + lane] * scale;
    if (gate) { const float* gr = gate + (size_t)row * gate_ld + grp * 128; oa *= siluf_(gr[lane]); oc *= siluf_(gr[64 + lane]); }
    float* orow = o + (size_t)row * 1024 + grp * 128;
    orow[lane] = oa; orow[64 + lane] = oc;
}

__global__ void __launch_bounds__(256) swa_naive(const float* __restrict__ qkv, const float* __restrict__ rel_bias, const float* __restrict__ sinks, float* __restrict__ o) {
    int bid = blockIdx.x;
    const int qblk = bid % (S / 256); bid /= (S / 256);
    const int hq = bid % 16; const int b = bid / 16;
    const int kvh = hq / 8;
    const int q = qblk * 256 + threadIdx.x;
    const float* qrow = qkv + (size_t)(b * S + q) * 1280 + hq * 64;
    float qq[64], O[64];
#pragma unroll
    for (int i = 0; i < 64; ++i) { qq[i] = qrow[i] * 0.125f; O[i] = 0.f; }
    const float sink = sinks[hq];
    float m = sink, l = 0.f;
    for (int j = 127; j >= 0; --j) {
        const int kv = q - j;
        if (kv < 0) continue;
        const float* krow = qkv + (size_t)(b * S + kv) * 1280 + 1024 + kvh * 64;
        const float* vrow = krow + 128;
        float d = 0.f;
#pragma unroll
        for (int i = 0; i < 64; ++i) d = fmaf(qq[i], krow[i], d);
        d += rel_bias[t5_bucket(j) * 16 + hq];
        const float n = fmaxf(m, d), a = expf(m - n), p = expf(d - n);
        l = l * a + p; m = n;
#pragma unroll
        for (int i = 0; i < 64; ++i) O[i] = O[i] * a + p * vrow[i];
    }
    const float den = l + expf(sink - m);
    float* orow = o + (size_t)(b * S + q) * 1024 + hq * 64;
#pragma unroll
    for (int i = 0; i < 64; ++i) orow[i] = O[i] / den;
}

__global__ void hg_prep_naive(float* __restrict__ proj, const float* __restrict__ lb) {
    const size_t i = (size_t)blockIdx.x * blockDim.x + threadIdx.x;
    const size_t row = i >> 10; const int c = (int)(i & 1023);
    float* r = proj + row * 4096;
    r[c] = siluf_(r[c]);
    const float l = lb[c];
    r[1024 + c] = l + (1.0f - l) * sigmoidf_(r[1024 + c]);
}
__global__ void __launch_bounds__(128) hg_scan_naive(const float* __restrict__ proj, float* __restrict__ o_raw) {
    const int b = blockIdx.x / 8, h = blockIdx.x % 8, dv = threadIdx.x;
    float St[128];
#pragma unroll
    for (int k = 0; k < 128; ++k) St[k] = 0.f;
    for (int t = 0; t < S; ++t) {
        const float* r = proj + (size_t)(b * S + t) * 4096;
        const float v = r[2048 + h * 128 + dv];
        const float* qr = r + h * 128; const float* fr = r + 1024 + h * 128;
        float o = 0.f;
#pragma unroll
        for (int k = 0; k < 128; ++k) { const float f = fr[k]; St[k] = f * St[k] + (1.0f - f) * v; o = fmaf(qr[k], St[k], o); }
        o_raw[(size_t)(b * S + t) * 1024 + h * 128 + dv] = o;
    }
}

static void gemm(hipStream_t st, const float* A, int lda, const float* W, int N, float* C, int ldc, int K, int epi) {
    dim3 grid(N / 128, M / 128);
    if (epi == 1) sgemm<1><<<grid, 256, 0, st>>>(A, lda, W, N, C, ldc, K);
    else sgemm<0><<<grid, 256, 0, st>>>(A, lda, W, N, C, ldc, K);
}

static void forward(void* const* d_in, float* out, unsigned char* ws, hipStream_t st) {
    const float* x = (const float*)d_in[0]; const float* p = (const float*)d_in[1]; const float* rel_bias = (const float*)d_in[2];
    const float* hg_lb = (const float*)d_in[3]; const float* da_w_in = (const float*)d_in[4]; const float* da_lambda = (const float*)d_in[5];
    const float* da_subln = (const float*)d_in[6]; const float* da_w_out = (const float*)d_in[7]; const float* hg_w_in = (const float*)d_in[8];
    const float* hg_gnorm = (const float*)d_in[9]; const float* hg_w_out = (const float*)d_in[10]; const float* sw_w_in = (const float*)d_in[11];
    const float* sw_sinks = (const float*)d_in[12]; const float* sw_w_out = (const float*)d_in[13]; const float* ln_g = (const float*)d_in[14];
    const float* ln_b = (const float*)d_in[15]; const float* w_up = (const float*)d_in[16]; const float* w_down = (const float*)d_in[17];
    const float* w_ple = (const float*)d_in[18]; const float* w_gate = (const float*)d_in[19];
    float* PROJ = (float*)ws;
    float* OB = (float*)(ws + (size_t)256 * 1048576);
    float* LB = (float*)(ws + (size_t)320 * 1048576);
    lb_kernel<<<4, 256, 0, st>>>(hg_lb, LB);
    const float* h = x;
    for (int i = 0; i < DEPTH; ++i) {
        const int kind = i % 3, j = i / 3;
        const float* w_out;
        if (kind == 0) {
            gemm(st, h, Dm, da_w_in + (size_t)j * 1024 * 3072, 3072, PROJ, 3072, 1024, 0);
            const float lam_init = 0.8f - 0.6f * expf(-0.3f * (float)i);
            da_attn_naive<<<(S / 256) * 8 * 8 * Bz, 256, 0, st>>>(PROJ, rel_bias, da_lambda + j * 256, lam_init, OB);
            rms128_kernel<<<M * 8 / 4, 256, 0, st>>>(OB, da_subln + j * 128, 1.0f - lam_init, nullptr, 0, OB);
            w_out = da_w_out + (size_t)j * 1024 * 1024;
        } else if (kind == 1) {
            gemm(st, h, Dm, hg_w_in + (size_t)j * 1024 * 4096, 4096, PROJ, 4096, 1024, 0);
            hg_prep_naive<<<M * 1024 / 256, 256, 0, st>>>(PROJ, LB + i * 1024);
            hg_scan_naive<<<32, 128, 0, st>>>(PROJ, OB);
            rms128_kernel<<<M * 8 / 4, 256, 0, st>>>(OB, hg_gnorm + j * 128, 1.0f, PROJ + 3072, 4096, OB);
            w_out = hg_w_out + (size_t)j * 1024 * 1024;
        } else {
            gemm(st, h, Dm, sw_w_in + (size_t)j * 1024 * 1280, 1280, PROJ, 1280, 1024, 0);
            swa_naive<<<(S / 256) * 16 * Bz, 256, 0, st>>>(PROJ, rel_bias, sw_sinks + j * 16, OB);
            w_out = sw_w_out + (size_t)j * 1024 * 1024;
        }
        gemm(st, OB, Dm, w_out, 1024, PROJ, 1024, 1024, 0);
        ln_kernel<<<M, 256, 0, st>>>(h, PROJ, ln_g + (i * 2 + 0) * 1024, ln_b + (i * 2 + 0) * 1024, out);
        h = out;
        gemm(st, h, Dm, w_up + (size_t)i * 1024 * 4096, 4096, PROJ, 4096, 1024, 1);
        gemm(st, PROJ, 4096, w_down + (size_t)i * 4096 * 1024, 1024, OB, 1024, 4096, 0);
        ln_kernel<<<M, 256, 0, st>>>(h, OB, ln_g + (i * 2 + 1) * 1024, ln_b + (i * 2 + 1) * 1024, out);
        gemm(st, h, Dm, w_gate + (size_t)i * 1024 * 1024, 1024, OB, 1024, 1024, 0);
        gemm(st, p + (size_t)i * M * PLE, PLE, w_ple + (size_t)i * PLE * 1024, 1024, PROJ, 1024, PLE, 0);
        ple_kernel<<<M * 1024 / 256, 256, 0, st>>>(out, OB, PROJ, M * 1024);
    }
}
}

extern "C" void kernel_launch(void* const* d_in, const int* in_sizes, int n_in, void* d_out, int out_size, void* d_ws, size_t ws_size, hipStream_t stream) {
    if (n_in != 20 || out_size != nv::M * nv::Dm || ws_size < (size_t)321 * 1048576) { fprintf(stderr, "kernel_launch: unexpected sizes n_in=%d out=%d ws=%zu\n", n_in, out_size, ws_size); return; }
    nv::forward(d_in, (float*)d_out, (unsigned char*)d_ws, stream);
}
```
